# Optimizing an MI355X kernel written in HIP

```python
import math
import jax, jax.numpy as jnp
from jax import lax
import numpy as np

D_MODEL = 1024
BATCH = 8
SEQ = 2048
DEPTH = 4

CHUNK = 64
HEAD_DIM = 64
N_MIX_HEADS = D_MODEL // HEAD_DIM
MEM_HEADS = 4
SELF_HEADS = N_MIX_HEADS - MEM_HEADS
SWA_KV_HEADS = 3
SWA_GROUP = SELF_HEADS // SWA_KV_HEADS
WINDOW = 128
WINDOW_CHUNKS = WINDOW // CHUNK
ROT_DIM = HEAD_DIM // 4
ROT_HALF = ROT_DIM // 2
ROPE_THETA = 500000.0
FOX_BLOCK = 128
MEM_LEN = 256
D_FF = ((8 * D_MODEL // 3 + 127) // 128) * 128
N_EXPERTS = 8
TOP_K = 2
EXPERT_BLOCK = 128
LN_EPS = 1e-5
NEG = -1e30
ATTN_SCALE = HEAD_DIM ** -0.5
DN_ALPHA = (2.0 * DEPTH) ** 0.25
DN_BETA = (8.0 * DEPTH) ** -0.25
N_SWA_LAYERS = (DEPTH + 1) // 2
N_FOX_LAYERS = DEPTH // 2
SWA_IN = (SELF_HEADS + 2 * SWA_KV_HEADS + MEM_HEADS) * HEAD_DIM
FOX_IN = (3 * SELF_HEADS + MEM_HEADS) * HEAD_DIM + SELF_HEADS

kernel_name = "hybrid_swa_fox_memxattn_deepnorm_moe"


def layer_norm(x, g, b):
    xf = x.astype(jnp.float32)
    mu = jnp.mean(xf, axis=-1, keepdims=True)
    var = jnp.mean(jnp.square(xf - mu), axis=-1, keepdims=True)
    return ((xf - mu) * lax.rsqrt(var + LN_EPS) * g + b).astype(x.dtype)


def rope_tables(positions):
    inv_freq = ROPE_THETA ** (-jnp.arange(0, ROT_DIM, 2, dtype=jnp.float32) / ROT_DIM)
    ang = positions.astype(jnp.float32)[..., None] * inv_freq
    return jnp.cos(ang)[:, :, None, :], jnp.sin(ang)[:, :, None, :]


def partial_rope(t, cos, sin):
    r = t[..., :ROT_DIM].astype(jnp.float32)
    r1, r2 = r[..., :ROT_HALF], r[..., ROT_HALF:]
    rot = jnp.concatenate([r1 * cos - r2 * sin, r2 * cos + r1 * sin], axis=-1)
    return jnp.concatenate([rot.astype(t.dtype), t[..., ROT_DIM:]], axis=-1)


def swa_sink_attention(q, k, v, sinks):
    B, S = q.shape[0], q.shape[1]
    n_c = S // CHUNK
    pad = WINDOW_CHUNKS * CHUNK
    n_keys = (WINDOW_CHUNKS + 1) * CHUNK
    qb = q.reshape(B, n_c, CHUNK, SWA_KV_HEADS, SWA_GROUP, HEAD_DIM)

    def band(t):
        tp = jnp.pad(t, ((0, 0), (pad, 0), (0, 0), (0, 0)))
        tp = tp.reshape(B, n_c + WINDOW_CHUNKS, CHUNK, SWA_KV_HEADS, HEAD_DIM)
        return jnp.concatenate([tp[:, m:m + n_c] for m in range(WINDOW_CHUNKS + 1)], axis=2)

    kb, vb = band(k), band(v)
    s = jnp.einsum('bnqhgd,bnkhd->bnhgqk', qb, kb).astype(jnp.float32) * ATTN_SCALE
    key_chunk = jnp.arange(n_c)[:, None] - WINDOW_CHUNKS + (jnp.arange(n_keys) // CHUNK)[None, :]
    valid = key_chunk >= 0
    s = jnp.where(valid[None, :, None, None, None, :], s, NEG)
    sk = sinks.astype(jnp.float32).reshape(SWA_KV_HEADS, SWA_GROUP)[None, None, :, :, None]
    m = jnp.maximum(jnp.max(s, axis=-1), sk)
    p = jnp.exp(s - m[..., None])
    den = jnp.sum(p, axis=-1) + jnp.exp(sk - m)
    probs = (p / den[..., None]).astype(v.dtype)
    o = jnp.einsum('bnhgqk,bnkhd->bnqhgd', probs, vb)
    return o.reshape(B, S, SELF_HEADS * HEAD_DIM)


def forgetting_attention(q, k, v, log_f):
    B, S = q.shape[0], q.shape[1]
    cum = jnp.cumsum(log_f, axis=1).transpose(0, 2, 1)
    outs = []
    for i in range(S // FOX_BLOCK):
        lo, hi = i * FOX_BLOCK, (i + 1) * FOX_BLOCK
        s = jnp.einsum('bqhd,bkhd->bhqk', q[:, lo:hi], k[:, :hi]).astype(jnp.float32) * ATTN_SCALE
        bias = cum[:, :, lo:hi, None] - cum[:, :, None, :hi]
        causal = jnp.arange(lo, hi)[:, None] >= jnp.arange(hi)[None, :]
        s = jnp.where(causal, s + bias, NEG)
        p = jax.nn.softmax(s, axis=-1).astype(v.dtype)
        outs.append(jnp.einsum('bhqk,bkhd->bqhd', p, v[:, :hi]))
    return jnp.concatenate(outs, axis=1).reshape(B, S, SELF_HEADS * HEAD_DIM)


def memory_attention(qc, km, vm):
    B, S = qc.shape[0], qc.shape[1]
    s = jnp.einsum('bshd,bmhd->bhsm', qc, km).astype(jnp.float32) * ATTN_SCALE
    p = jax.nn.softmax(s, axis=-1).astype(vm.dtype)
    return jnp.einsum('bhsm,bmhd->bshd', p, vm).reshape(B, S, MEM_HEADS * HEAD_DIM)


def swiglu(x, w_in, w_out):
    h = x @ w_in
    a, b = h[..., :D_FF], h[..., D_FF:]
    return (jax.nn.silu(a) * b) @ w_out


def moe_swiglu(x, w_router, b_router, w_in, w_out):
    shp = x.shape
    x2 = x.reshape(-1, shp[-1])
    n_tok = x2.shape[0]
    logits = (x2 @ w_router).astype(jnp.float32) + b_router.astype(jnp.float32)
    top_vals, top_idx = lax.top_k(logits, TOP_K)
    gates = jax.nn.softmax(top_vals, axis=-1)
    n_asg = n_tok * TOP_K
    e_flat = top_idx.reshape(-1)
    t_flat = jnp.repeat(jnp.arange(n_tok, dtype=jnp.int32), TOP_K)
    g_flat = gates.reshape(-1)
    order = jnp.argsort(e_flat)
    se, st, sg = e_flat[order], t_flat[order], g_flat[order]
    counts = jnp.bincount(e_flat, length=N_EXPERTS)
    starts = jnp.cumsum(counts) - counts
    pcounts = (counts + EXPERT_BLOCK - 1) // EXPERT_BLOCK * EXPERT_BLOCK
    pends = jnp.cumsum(pcounts)
    pstarts = pends - pcounts
    dest = pstarts[se] + (jnp.arange(n_asg) - starts[se])
    n_blocks = -(-n_asg // EXPERT_BLOCK) + N_EXPERTS
    n_slots = n_blocks * EXPERT_BLOCK
    slot_tok = jnp.zeros((n_slots,), jnp.int32).at[dest].set(st)
    slot_gate = jnp.zeros((n_slots,), x2.dtype).at[dest].set(sg.astype(x2.dtype))
    block_exp = jnp.minimum(
        jnp.searchsorted(pends, jnp.arange(n_blocks) * EXPERT_BLOCK, side='right'), N_EXPERTS - 1)
    xs = x2[slot_tok].reshape(n_blocks, EXPERT_BLOCK, shp[-1])

    def expert_block(args):
        xb, e = args
        h = xb @ w_in[e]
        return (jax.nn.silu(h[:, :D_FF]) * h[:, D_FF:]) @ w_out[e]

    ys = lax.map(expert_block, (xs, block_exp)).reshape(n_slots, shp[-1])
    y = jnp.zeros_like(x2).at[slot_tok].add((ys * slot_gate[:, None]).astype(x2.dtype))
    return y.reshape(shp)


def setup_inputs(seed: int = 0) -> dict:
    key = jax.random.key(seed)
    ks = jax.random.split(key, 20)
    nrm = jax.random.normal
    f32 = jnp.float32
    x = nrm(ks[0], (BATCH, SEQ, D_MODEL), f32)
    mem = nrm(ks[1], (BATCH, MEM_LEN, D_MODEL), f32)
    offset = jax.random.randint(ks[2], (BATCH, 1), 0, 1 << 16, dtype=jnp.int32)
    positions = offset + jnp.arange(SEQ, dtype=jnp.int32)[None, :]
    sd = D_MODEL ** -0.5
    sf = D_FF ** -0.5
    return {
        "x": x,
        "mem": mem,
        "positions": positions,
        "w_in_swa": nrm(ks[3], (N_SWA_LAYERS, D_MODEL, SWA_IN), f32) * sd,
        "attn_sinks": nrm(ks[4], (N_SWA_LAYERS, SELF_HEADS), f32) * 0.5,
        "w_in_fox": nrm(ks[5], (N_FOX_LAYERS, D_MODEL, FOX_IN), f32) * sd,
        "b_forget": jax.random.uniform(ks[6], (N_FOX_LAYERS, SELF_HEADS), f32, 1.0, 4.0),
        "w_mem_kv": nrm(ks[7], (DEPTH, D_MODEL, 2 * MEM_HEADS * HEAD_DIM), f32) * sd,
        "w_out": nrm(ks[8], (DEPTH, D_MODEL, D_MODEL), f32) * sd * DN_BETA,
        "ln_attn_g": 1.0 + 0.02 * nrm(ks[9], (DEPTH, D_MODEL), f32),
        "ln_attn_b": 0.02 * nrm(ks[10], (DEPTH, D_MODEL), f32),
        "w_ffn_in": nrm(ks[11], (N_SWA_LAYERS, D_MODEL, 2 * D_FF), f32) * sd,
        "w_ffn_out": nrm(ks[12], (N_SWA_LAYERS, D_FF, D_MODEL), f32) * sf * DN_BETA,
        "w_router": nrm(ks[13], (N_FOX_LAYERS, D_MODEL, N_EXPERTS), f32) * sd,
        "b_router": 0.01 * nrm(ks[14], (N_FOX_LAYERS, N_EXPERTS), f32),
        "w_exp_in": nrm(ks[15], (N_FOX_LAYERS, N_EXPERTS, D_MODEL, 2 * D_FF), f32) * sd,
        "w_exp_out": nrm(ks[16], (N_FOX_LAYERS, N_EXPERTS, D_FF, D_MODEL), f32) * sf * DN_BETA,
        "ln_ffn_g": 1.0 + 0.02 * nrm(ks[17], (DEPTH, D_MODEL), f32),
        "ln_ffn_b": 0.02 * nrm(ks[18], (DEPTH, D_MODEL), f32),
    }


def reference(x, mem, positions, w_in_swa, attn_sinks, w_in_fox, b_forget, w_mem_kv, w_out,
              ln_attn_g, ln_attn_b, w_ffn_in, w_ffn_out, w_router, b_router, w_exp_in,
              w_exp_out, ln_ffn_g, ln_ffn_b):
    B, S = x.shape[0], x.shape[1]
    cos, sin = rope_tables(positions)
    hq = SELF_HEADS * HEAD_DIM
    hkv = SWA_KV_HEADS * HEAD_DIM
    hm = MEM_HEADS * HEAD_DIM
    for i in range(DEPTH):
        j = i // 2
        kvm = mem @ w_mem_kv[i]
        km = kvm[..., :hm].reshape(B, MEM_LEN, MEM_HEADS, HEAD_DIM)
        vm = kvm[..., hm:].reshape(B, MEM_LEN, MEM_HEADS, HEAD_DIM)
        if i % 2 == 0:
            proj = x @ w_in_swa[j]
            q = proj[..., :hq].reshape(B, S, SELF_HEADS, HEAD_DIM)
            k = proj[..., hq:hq + hkv].reshape(B, S, SWA_KV_HEADS, HEAD_DIM)
            v = proj[..., hq + hkv:hq + 2 * hkv].reshape(B, S, SWA_KV_HEADS, HEAD_DIM)
            qc = proj[..., hq + 2 * hkv:].reshape(B, S, MEM_HEADS, HEAD_DIM)
            q, k = partial_rope(q, cos, sin), partial_rope(k, cos, sin)
            self_out = swa_sink_attention(q, k, v, attn_sinks[j])
        else:
            proj = x @ w_in_fox[j]
            q = proj[..., :hq].reshape(B, S, SELF_HEADS, HEAD_DIM)
            k = proj[..., hq:2 * hq].reshape(B, S, SELF_HEADS, HEAD_DIM)
            v = proj[..., 2 * hq:3 * hq].reshape(B, S, SELF_HEADS, HEAD_DIM)
            qc = proj[..., 3 * hq:3 * hq + hm].reshape(B, S, MEM_HEADS, HEAD_DIM)
            f_logit = proj[..., 3 * hq + hm:].astype(jnp.float32) + b_forget[j].astype(jnp.float32)
            log_f = jax.nn.log_sigmoid(f_logit)
            self_out = forgetting_attention(q, k, v, log_f)
        cross_out = memory_attention(qc, km, vm)
        mix = jnp.concatenate([self_out, cross_out], axis=-1) @ w_out[i]
        x = layer_norm(DN_ALPHA * x + mix, ln_attn_g[i], ln_attn_b[i])
        if i % 2 == 0:
            ffn = swiglu(x, w_ffn_in[j], w_ffn_out[j])
        else:
            ffn = moe_swiglu(x, w_router[j], b_router[j], w_exp_in[j], w_exp_out[j])
        x = layer_norm(DN_ALPHA * x + ffn, ln_ffn_g[i], ln_ffn_b[i])
    return x
```

```cpp
#include <hip/hip_runtime.h>
#include <stdint.h>
#include <stddef.h>

typedef unsigned short bf16_t;
typedef short bf16x8 __attribute__((ext_vector_type(8)));
typedef float f32x4 __attribute__((ext_vector_type(4)));
typedef unsigned u32x4 __attribute__((ext_vector_type(4)));

constexpr int D = 1024, BATCH = 8, SEQ = 2048, M = BATCH * SEQ, DEPTH = 4;
constexpr int HD = 64, SELF_H = 12, MEM_H = 4, KV_H = 3, MEM_LEN = 256, MROWS = BATCH * MEM_LEN;
constexpr int DFF = 2816, NEXP = 8;
constexpr int SWA_IN = 1408, FOX_IN = 2572, FOX_P = 2560;
constexpr float LN_EPS = 1e-5f, ATTN_SCALE = 0.125f;
constexpr float DN_ALPHA = 1.6817928305074292f;
constexpr int NSLOT_MAX = 2 * M + NEXP * 256;

__device__ __forceinline__ unsigned f2bf(float f) { unsigned u = __float_as_uint(f); return (u + 0x7fffu + ((u >> 16) & 1u)) >> 16; }
__device__ __forceinline__ float bf2f(bf16_t b) { return __uint_as_float(((unsigned)b) << 16); }

template <int MAP> __device__ __forceinline__ int src_col(int np, int N) {
    if (MAP == 0) return np < N ? np : -1;
    const int g = np >> 5, t = np & 31; return t < 16 ? 16 * g + t : DFF + 16 * g + (t - 16);
}
template <int MAP>
__global__ __launch_bounds__(256) void k_wt(const float* __restrict__ W, bf16_t* __restrict__ Wt, int K, int N, int Np, size_t wstride, size_t wtstride) {
    __shared__ float tile[32][33];
    W += (size_t)blockIdx.z * wstride; Wt += (size_t)blockIdx.z * wtstride;
    const int tx = threadIdx.x & 31, ty = threadIdx.x >> 5;
    const int n0 = blockIdx.x * 32, k0 = blockIdx.y * 32;
    const int sc = src_col<MAP>(n0 + tx, N);
#pragma unroll
    for (int j = 0; j < 4; ++j) { const int k = k0 + ty + 8 * j; tile[ty + 8 * j][tx] = sc >= 0 ? W[(size_t)k * N + sc] : 0.f; }
    __syncthreads();
#pragma unroll
    for (int j = 0; j < 4; ++j) { const int n = n0 + ty + 8 * j; Wt[(size_t)n * K + k0 + tx] = (bf16_t)f2bf(tile[tx][ty + 8 * j]); }
}

__global__ void k_cvt_bf16(const float* __restrict__ in, bf16_t* __restrict__ out, size_t n) {
    size_t i = (size_t)blockIdx.x * blockDim.x + threadIdx.x; const size_t st = (size_t)gridDim.x * blockDim.x;
    for (; i < n; i += st) out[i] = (bf16_t)f2bf(in[i]);
}
__global__ void k_copy_f32(const float* __restrict__ in, float* __restrict__ out, size_t n4) {
    size_t i = (size_t)blockIdx.x * blockDim.x + threadIdx.x; const size_t st = (size_t)gridDim.x * blockDim.x;
    for (; i < n4; i += st) ((f32x4*)out)[i] = ((const f32x4*)in)[i];
}

__device__ __forceinline__ void sincos_acc(double ang, float& c, float& s) {
    const double two_over_pi = 0.63661977236758134308, pio2_hi = 1.57079632679489655800e+00, pio2_lo = 6.12323399573676603587e-17;
    const double kd = rint(ang * two_over_pi); const long long k = (long long)kd;
    double r = fma(-kd, pio2_hi, ang); r = fma(-kd, pio2_lo, r);
    const double r2 = r * r;
    double sp = r * (1.0 + r2 * (-1.0 / 6 + r2 * (1.0 / 120 + r2 * (-1.0 / 5040 + r2 * (1.0 / 362880 + r2 * (-1.0 / 39916800 + r2 * (1.0 / 6227020800.0)))))));
    double cp = 1.0 + r2 * (-0.5 + r2 * (1.0 / 24 + r2 * (-1.0 / 720 + r2 * (1.0 / 40320 + r2 * (-1.0 / 3628800 + r2 * (1.0 / 479001600.0))))));
    const int q = (int)(k & 3);
    double cc = (q == 0) ? cp : (q == 1) ? -sp : (q == 2) ? -cp : sp;
    double ss = (q == 0) ? sp : (q == 1) ? cp : (q == 2) ? -sp : -cp;
    c = (float)cc; s = (float)ss;
}
__global__ void k_rope_table(const int* __restrict__ pos, float* __restrict__ cs) {
    const int i = blockIdx.x * blockDim.x + threadIdx.x; if (i >= M * 8) return;
    const int m = i >> 3, d = i & 7;
    const float invf = (float)exp(-(double)d / 8.0 * log(500000.0));
    const float angf = (float)pos[m] * invf;
    float c, s; sincos_acc((double)angf, c, s);
    cs[m * 16 + d] = c; cs[m * 16 + 8 + d] = s;
}

struct GemmMeta { const int* counts; int expert; };
template <class Epi>
__global__ __launch_bounds__(256) void k_gemm(const bf16_t* __restrict__ A, int lda, const bf16_t* __restrict__ Bt, int ldb, int K, Epi epi, const int* meta, int expert) {
    const int wid = threadIdx.x >> 6, lane = threadIdx.x & 63, wr = wid >> 1, wc = wid & 1, fr = lane & 15, fq = lane >> 4;
    int rbase = 0;
    if (meta) { const int cnt = meta[expert]; if ((int)blockIdx.y * 128 >= cnt) return; rbase = meta[8 + expert]; }
    const int row0 = rbase + blockIdx.y * 128 + wr * 64, col0 = blockIdx.x * 128 + wc * 64;
    f32x4 acc[4][4];
#pragma unroll
    for (int i = 0; i < 4; ++i)
#pragma unroll
        for (int j = 0; j < 4; ++j) acc[i][j] = (f32x4){0.f, 0.f, 0.f, 0.f};
    const bf16_t* Ap = A + (size_t)(row0 + fr) * lda + fq * 8;
    const bf16_t* Bp = Bt + (size_t)(col0 + fr) * ldb + fq * 8;
    for (int k0 = 0; k0 < K; k0 += 32) {
        bf16x8 a[4], b[4];
#pragma unroll
        for (int i = 0; i < 4; ++i) a[i] = *(const bf16x8*)(Ap + (size_t)(i * 16) * lda + k0);
#pragma unroll
        for (int j = 0; j < 4; ++j) b[j] = *(const bf16x8*)(Bp + (size_t)(j * 16) * ldb + k0);
#pragma unroll
        for (int i = 0; i < 4; ++i)
#pragma unroll
            for (int j = 0; j < 4; ++j) acc[i][j] = __builtin_amdgcn_mfma_f32_16x16x32_bf16(a[i], b[j], acc[i][j], 0, 0, 0);
    }
    epi.run(acc, row0, col0, fr, fq);
}
struct EpiF32 { float* C; int ldc; int N;
    __device__ __forceinline__ void run(const f32x4 (&acc)[4][4], int row0, int col0, int fr, int fq) const {
#pragma unroll
        for (int i = 0; i < 4; ++i)
#pragma unroll
            for (int j = 0; j < 4; ++j)
#pragma unroll
                for (int r = 0; r < 4; ++r) { const int row = row0 + 16 * i + 4 * fq + r, col = col0 + 16 * j + fr; if (col < N) C[(size_t)row * ldc + col] = acc[i][j][r]; } } };
struct EpiBf16 { bf16_t* C; int ldc; int N;
    __device__ __forceinline__ void run(const f32x4 (&acc)[4][4], int row0, int col0, int fr, int fq) const {
#pragma unroll
        for (int i = 0; i < 4; ++i)
#pragma unroll
            for (int j = 0; j < 4; ++j)
#pragma unroll
                for (int r = 0; r < 4; ++r) { const int row = row0 + 16 * i + 4 * fq + r, col = col0 + 16 * j + fr; if (col < N) C[(size_t)row * ldc + col] = (bf16_t)f2bf(acc[i][j][r]); } } };
struct EpiSwiglu { bf16_t* H; int ldh;
    __device__ __forceinline__ void run(const f32x4 (&acc)[4][4], int row0, int col0, int fr, int fq) const {
#pragma unroll
        for (int i = 0; i < 4; ++i)
#pragma unroll
            for (int jj = 0; jj < 2; ++jj)
#pragma unroll
                for (int r = 0; r < 4; ++r) { const int row = row0 + 16 * i + 4 * fq + r; const int hc = (col0 + 32 * jj) / 2 + fr;
                    const float a = acc[i][2 * jj][r], b = acc[i][2 * jj + 1][r]; const float s = a / (1.f + __expf(-a));
                    H[(size_t)row * ldh + hc] = (bf16_t)f2bf(s * b); } } };

__global__ void k_post_swa(const float* __restrict__ T, const float* __restrict__ cs, bf16_t* __restrict__ P) {
    const size_t i = (size_t)blockIdx.x * blockDim.x + threadIdx.x; if (i >= (size_t)M * SWA_IN) return;
    const int m = (int)(i / SWA_IN), c = (int)(i % SWA_IN);
    float v = T[i];
    if (c < 960) { const int d = c & 63; if (d < 16) { const int dd = d & 7; const float co = cs[m * 16 + dd], si = cs[m * 16 + 8 + dd];
            if (d < 8) v = v * co - T[i + 8] * si; else v = v * co + T[i - 8] * si; } }
    P[i] = (bf16_t)f2bf(v);
}
__global__ void k_post_fox(const float* __restrict__ T, const float* __restrict__ bfg, bf16_t* __restrict__ P, float* __restrict__ logf) {
    const size_t i = (size_t)blockIdx.x * blockDim.x + threadIdx.x; if (i >= (size_t)M * FOX_IN) return;
    const int m = (int)(i / FOX_IN), c = (int)(i % FOX_IN);
    const float v = T[i];
    if (c < FOX_P) P[(size_t)m * FOX_P + c] = (bf16_t)f2bf(v);
    else { const float z = v + bfg[c - FOX_P];
        logf[m * 12 + (c - FOX_P)] = fminf(z, 0.f) - log1pf(expf(-fabsf(z))); }
}
__global__ __launch_bounds__(64) void k_cumsum(const float* __restrict__ logf, float* __restrict__ cum) {
    const int b = blockIdx.x / 12, h = blockIdx.x % 12, lane = threadIdx.x;
    double carry = 0.0;
    for (int t0 = 0; t0 < SEQ; t0 += 64) {
        float v = logf[(size_t)(b * SEQ + t0 + lane) * 12 + h];
#pragma unroll
        for (int o = 1; o < 64; o <<= 1) { const float u = __shfl_up(v, o); if (lane >= o) v += u; }
        cum[(size_t)(b * 12 + h) * SEQ + t0 + lane] = (float)(carry + (double)v);
        carry += (double)__shfl(v, 63);
    }
}

template <int MODE>
__global__ __launch_bounds__(64) void k_attn(const bf16_t* __restrict__ P, int pitch, const bf16_t* __restrict__ KVM, const float* __restrict__ aux, bf16_t* __restrict__ O) {
    __shared__ float Ks[64][64]; __shared__ float Vs[64][64];
    const int qb = blockIdx.x, h = blockIdx.y, b = blockIdx.z, t = threadIdx.x;
    const int qpos = qb * 64 + t; const size_t qrow = (size_t)b * SEQ + qpos;
    int qoff, koff, voff, kpitch, ocol; const bf16_t* KV; size_t kvrow0; int klo, khi;
    if (MODE == 0) { qoff = h * 64; koff = 768 + (h / 4) * 64; voff = 960 + (h / 4) * 64; kpitch = pitch; KV = P; kvrow0 = (size_t)b * SEQ; klo = (qb >= 2 ? qb - 2 : 0) * 64; khi = (qb + 1) * 64; ocol = h * 64; }
    else if (MODE == 1) { qoff = h * 64; koff = 768 + h * 64; voff = 1536 + h * 64; kpitch = pitch; KV = P; kvrow0 = (size_t)b * SEQ; klo = 0; khi = (qb + 1) * 64; ocol = h * 64; }
    else { qoff = (pitch == SWA_IN ? 1152 : 2304) + h * 64; koff = h * 64; voff = 256 + h * 64; kpitch = 512; KV = KVM; kvrow0 = (size_t)b * MEM_LEN; klo = 0; khi = MEM_LEN; ocol = 768 + h * 64; }
    float q[64], o[64];
    { const bf16_t* qp = P + qrow * pitch + qoff;
#pragma unroll
      for (int d = 0; d < 64; ++d) { q[d] = bf2f(qp[d]) * ATTN_SCALE; o[d] = 0.f; } }
    float mrun, lrun, cq = 0.f; const float* cumk = nullptr;
    if (MODE == 0) { mrun = aux[h]; lrun = 1.f; } else { mrun = -1e30f; lrun = 0.f; }
    if (MODE == 1) { cumk = aux + (size_t)(b * 12 + h) * SEQ; cq = cumk[qpos]; }
    for (int k0 = klo; k0 < khi; k0 += 64) {
        __syncthreads();
#pragma unroll
        for (int i = 0; i < 8; ++i) { const int c = t + 64 * i, r = c >> 3, c8 = (c & 7) * 8; const bf16_t* kp = KV + (kvrow0 + k0 + r) * kpitch;
            const bf16x8 kv = *(const bf16x8*)(kp + koff + c8), vv = *(const bf16x8*)(kp + voff + c8);
#pragma unroll
            for (int e = 0; e < 8; ++e) { Ks[r][c8 + e] = bf2f((bf16_t)kv[e]); Vs[r][c8 + e] = bf2f((bf16_t)vv[e]); } }
        __syncthreads();
        for (int j0 = 0; j0 < 64; j0 += 8) {
            float s[8];
#pragma unroll
            for (int jj = 0; jj < 8; ++jj) { float a = 0.f;
#pragma unroll
                for (int d = 0; d < 64; d += 4) { const f32x4 kk = *(const f32x4*)&Ks[j0 + jj][d]; a += q[d] * kk[0] + q[d + 1] * kk[1] + q[d + 2] * kk[2] + q[d + 3] * kk[3]; }
                if (MODE == 1) { const int kpos = k0 + j0 + jj; a = (kpos <= qpos) ? a + cq - cumk[kpos] : -1e30f; }
                s[jj] = a; }
            float mx = s[0];
#pragma unroll
            for (int jj = 1; jj < 8; ++jj) mx = fmaxf(mx, s[jj]);
            const float mnew = fmaxf(mrun, mx), corr = __expf(mrun - mnew); mrun = mnew; lrun *= corr;
#pragma unroll
            for (int d = 0; d < 64; ++d) o[d] *= corr;
#pragma unroll
            for (int jj = 0; jj < 8; ++jj) { const float p = __expf(s[jj] - mnew); lrun += p;
#pragma unroll
                for (int d = 0; d < 64; d += 4) { const f32x4 vv = *(const f32x4*)&Vs[j0 + jj][d]; o[d] += p * vv[0]; o[d + 1] += p * vv[1]; o[d + 2] += p * vv[2]; o[d + 3] += p * vv[3]; } }
        }
    }
    const float inv = 1.f / lrun; bf16_t* op = O + qrow * D + ocol;
#pragma unroll
    for (int d = 0; d < 64; ++d) op[d] = (bf16_t)f2bf(o[d] * inv);
}

__device__ __forceinline__ float wave_sum(float v) {
#pragma unroll
    for (int o = 1; o < 64; o <<= 1) v += __shfl_xor(v, o);
    return v;
}
__device__ __forceinline__ void ln_finish(f32x4 (&v)[4], const float* g, const float* be, float* xo, bf16_t* xb, int lane) {
    float s = 0.f;
#pragma unroll
    for (int j = 0; j < 4; ++j) s += (v[j][0] + v[j][1]) + (v[j][2] + v[j][3]);
    const float mean = wave_sum(s) * (1.f / D); float s2 = 0.f;
#pragma unroll
    for (int j = 0; j < 4; ++j) { v[j] = v[j] - mean; s2 += (v[j][0] * v[j][0] + v[j][1] * v[j][1]) + (v[j][2] * v[j][2] + v[j][3] * v[j][3]); }
    const float rstd = 1.f / sqrtf(wave_sum(s2) * (1.f / D) + LN_EPS);
#pragma unroll
    for (int j = 0; j < 4; ++j) { const int c = 4 * lane + 256 * j; const f32x4 gg = *(const f32x4*)(g + c), bb = *(const f32x4*)(be + c);
        const f32x4 r = v[j] * rstd * gg + bb; *(f32x4*)(xo + c) = r;
        xb[c] = (bf16_t)f2bf(r[0]); xb[c + 1] = (bf16_t)f2bf(r[1]); xb[c + 2] = (bf16_t)f2bf(r[2]); xb[c + 3] = (bf16_t)f2bf(r[3]); }
}
__global__ __launch_bounds__(256) void k_ln(const float* __restrict__ xin, const float* __restrict__ y, const float* __restrict__ g, const float* __restrict__ be, float* __restrict__ xo, bf16_t* __restrict__ xb) {
    const int row = blockIdx.x * 4 + (threadIdx.x >> 6), lane = threadIdx.x & 63;
    f32x4 v[4];
#pragma unroll
    for (int j = 0; j < 4; ++j) { const int c = 4 * lane + 256 * j; v[j] = *(const f32x4*)(xin + (size_t)row * D + c) * DN_ALPHA + *(const f32x4*)(y + (size_t)row * D + c); }
    ln_finish(v, g, be, xo + (size_t)row * D, xb + (size_t)row * D, lane);
}
__global__ __launch_bounds__(256) void k_ln_moe(const float* __restrict__ xin, const float* __restrict__ ys, const int* __restrict__ tokslot, const float* __restrict__ tokgate, const float* __restrict__ g, const float* __restrict__ be, float* __restrict__ xo, bf16_t* __restrict__ xb) {
    const int row = blockIdx.x * 4 + (threadIdx.x >> 6), lane = threadIdx.x & 63;
    const int s1 = tokslot[2 * row], s2 = tokslot[2 * row + 1]; const float g1 = tokgate[2 * row], g2 = tokgate[2 * row + 1];
    f32x4 v[4];
#pragma unroll
    for (int j = 0; j < 4; ++j) { const int c = 4 * lane + 256 * j;
        v[j] = *(const f32x4*)(xin + (size_t)row * D + c) * DN_ALPHA + *(const f32x4*)(ys + (size_t)s1 * D + c) * g1 + *(const f32x4*)(ys + (size_t)s2 * D + c) * g2; }
    ln_finish(v, g, be, xo + (size_t)row * D, xb + (size_t)row * D, lane);
}

__global__ __launch_bounds__(256) void k_router(const float* __restrict__ x, const float* __restrict__ wr, const float* __restrict__ br, int* __restrict__ meta, int* __restrict__ tokexp, int* __restrict__ tokpos, float* __restrict__ tokgate) {
    const int row = blockIdx.x * 4 + (threadIdx.x >> 6), lane = threadIdx.x & 63;
    float acc[8];
#pragma unroll
    for (int e = 0; e < 8; ++e) acc[e] = 0.f;
#pragma unroll
    for (int j = 0; j < 4; ++j) { const int c = 4 * lane + 256 * j; const f32x4 xv = *(const f32x4*)(x + (size_t)row * D + c);
#pragma unroll
        for (int i = 0; i < 4; ++i) { const f32x4 w0 = *(const f32x4*)(wr + (size_t)(c + i) * 8), w1 = *(const f32x4*)(wr + (size_t)(c + i) * 8 + 4);
            acc[0] += xv[i] * w0[0]; acc[1] += xv[i] * w0[1]; acc[2] += xv[i] * w0[2]; acc[3] += xv[i] * w0[3];
            acc[4] += xv[i] * w1[0]; acc[5] += xv[i] * w1[1]; acc[6] += xv[i] * w1[2]; acc[7] += xv[i] * w1[3]; } }
#pragma unroll
    for (int e = 0; e < 8; ++e) acc[e] = wave_sum(acc[e]) + br[e];
    if (lane == 0) {
        int e1 = 0; float v1 = acc[0];
#pragma unroll
        for (int e = 1; e < 8; ++e) if (acc[e] > v1) { v1 = acc[e]; e1 = e; }
        int e2 = -1; float v2 = -3.4e38f;
#pragma unroll
        for (int e = 0; e < 8; ++e) if (e != e1 && acc[e] > v2) { v2 = acc[e]; e2 = e; }
        const float p2 = __expf(v2 - v1), g1 = 1.f / (1.f + p2), g2 = p2 / (1.f + p2);
        tokexp[2 * row] = e1; tokexp[2 * row + 1] = e2; tokgate[2 * row] = g1; tokgate[2 * row + 1] = g2;
        tokpos[2 * row] = atomicAdd(&meta[e1], 1); tokpos[2 * row + 1] = atomicAdd(&meta[e2], 1);
    }
}
__global__ void k_starts(int* meta) { if (threadIdx.x == 0) { int s = 0; for (int e = 0; e < 8; ++e) { meta[8 + e] = s; s += (meta[e] + 255) / 256 * 256; } } }
__global__ __launch_bounds__(256) void k_scatter(const bf16_t* __restrict__ xb, const int* __restrict__ meta, const int* __restrict__ tokexp, const int* __restrict__ tokpos, int* __restrict__ tokslot, bf16_t* __restrict__ xs) {
    const int row = blockIdx.x * 4 + (threadIdx.x >> 6), lane = threadIdx.x & 63;
    const int s1 = meta[8 + tokexp[2 * row]] + tokpos[2 * row], s2 = meta[8 + tokexp[2 * row + 1]] + tokpos[2 * row + 1];
    if (lane == 0) { tokslot[2 * row] = s1; tokslot[2 * row + 1] = s2; }
    const u32x4 a = ((const u32x4*)(xb + (size_t)row * D))[lane], b2 = ((const u32x4*)(xb + (size_t)row * D))[lane + 64];
    ((u32x4*)(xs + (size_t)s1 * D))[lane] = a; ((u32x4*)(xs + (size_t)s1 * D))[lane + 64] = b2;
    ((u32x4*)(xs + (size_t)s2 * D))[lane] = a; ((u32x4*)(xs + (size_t)s2 * D))[lane + 64] = b2;
}

constexpr size_t MiB = 1u << 20;
constexpr size_t al(size_t x) { return (x + 255) & ~(size_t)255; }
constexpr size_t SWA_NP = 1408, FOX_NP = 2688  ;
constexpr size_t SZ_WT_SWA = 2 * SWA_NP * D * 2, SZ_WT_FOX = 2 * FOX_NP * D * 2, SZ_WT_MKV = 4 * 512 * D * 2, SZ_WT_OUT = 4 * (size_t)D * D * 2,
                 SZ_WT_FIN = 2 * (size_t)2 * DFF * D * 2, SZ_WT_FOUT = 2 * (size_t)D * DFF * 2, SZ_WT_EIN = 16 * (size_t)2 * DFF * D * 2, SZ_WT_EOUT = 16 * (size_t)D * DFF * 2;
constexpr size_t OFF_META = 0;
constexpr size_t OFF_WT_SWA = 1 * MiB;
constexpr size_t OFF_WT_FOX = OFF_WT_SWA + al(SZ_WT_SWA);
constexpr size_t OFF_WT_MKV = OFF_WT_FOX + al(SZ_WT_FOX);
constexpr size_t OFF_WT_OUT = OFF_WT_MKV + al(SZ_WT_MKV);
constexpr size_t OFF_WT_FIN = OFF_WT_OUT + al(SZ_WT_OUT);
constexpr size_t OFF_WT_FOUT = OFF_WT_FIN + al(SZ_WT_FIN);
constexpr size_t OFF_WT_EIN = OFF_WT_FOUT + al(SZ_WT_FOUT);
constexpr size_t OFF_WT_EOUT = OFF_WT_EIN + al(SZ_WT_EIN);
constexpr size_t OFF_X32 = OFF_WT_EOUT + al(SZ_WT_EOUT);
constexpr size_t OFF_XB = OFF_X32 + al((size_t)M * D * 4);
constexpr size_t OFF_MEMB = OFF_XB + al((size_t)M * D * 2);
constexpr size_t OFF_KVM = OFF_MEMB + al((size_t)MROWS * D * 2);
constexpr size_t OFF_CS = OFF_KVM + al((size_t)4 * MROWS * 512 * 2);
constexpr size_t OFF_P = OFF_CS + al((size_t)M * 16 * 4);
constexpr size_t OFF_TMP = OFF_P + al((size_t)M * FOX_P * 2);
constexpr size_t OFF_LOGF = OFF_TMP + al((size_t)M * FOX_IN * 4);
constexpr size_t OFF_CUM = OFF_LOGF + al((size_t)M * 12 * 4);
constexpr size_t OFF_O = OFF_CUM + al((size_t)M * 12 * 4);
constexpr size_t OFF_H = OFF_O + al((size_t)M * D * 2);
constexpr size_t OFF_XS = OFF_H + al((size_t)NSLOT_MAX * DFF * 2);
constexpr size_t OFF_YS = OFF_XS + al((size_t)NSLOT_MAX * D * 2);
constexpr size_t OFF_TOK = OFF_YS + al((size_t)NSLOT_MAX * D * 4);
constexpr size_t WS_END = OFF_TOK + 4 * al((size_t)2 * M * 4);

extern "C" void kernel_launch(void* const* d_in, const int* in_sizes, int n_in, void* d_out, int out_size, void* d_ws, size_t ws_size, hipStream_t stream) {
    if (ws_size < WS_END) return;
    const float* x_in = (const float*)d_in[0]; const float* mem = (const float*)d_in[1]; const int* pos = (const int*)d_in[2];
    const float* w_in_swa = (const float*)d_in[3]; const float* sinks = (const float*)d_in[4]; const float* w_in_fox = (const float*)d_in[5];
    const float* b_forget = (const float*)d_in[6]; const float* w_mem_kv = (const float*)d_in[7]; const float* w_out = (const float*)d_in[8];
    const float* ln_a_g = (const float*)d_in[9]; const float* ln_a_b = (const float*)d_in[10]; const float* w_ffn_in = (const float*)d_in[11];
    const float* w_ffn_out = (const float*)d_in[12]; const float* w_router = (const float*)d_in[13]; const float* b_router = (const float*)d_in[14];
    const float* w_exp_in = (const float*)d_in[15]; const float* w_exp_out = (const float*)d_in[16]; const float* ln_f_g = (const float*)d_in[17]; const float* ln_f_b = (const float*)d_in[18];
    char* ws = (char*)d_ws; float* out = (float*)d_out;
    int* meta = (int*)(ws + OFF_META);
    bf16_t* wt_swa = (bf16_t*)(ws + OFF_WT_SWA); bf16_t* wt_fox = (bf16_t*)(ws + OFF_WT_FOX); bf16_t* wt_mkv = (bf16_t*)(ws + OFF_WT_MKV); bf16_t* wt_out = (bf16_t*)(ws + OFF_WT_OUT);
    bf16_t* wt_fin = (bf16_t*)(ws + OFF_WT_FIN); bf16_t* wt_fout = (bf16_t*)(ws + OFF_WT_FOUT); bf16_t* wt_ein = (bf16_t*)(ws + OFF_WT_EIN); bf16_t* wt_eout = (bf16_t*)(ws + OFF_WT_EOUT);
    float* x32 = (float*)(ws + OFF_X32); bf16_t* xb = (bf16_t*)(ws + OFF_XB); bf16_t* memb = (bf16_t*)(ws + OFF_MEMB); bf16_t* kvm = (bf16_t*)(ws + OFF_KVM);
    float* cs = (float*)(ws + OFF_CS); bf16_t* P = (bf16_t*)(ws + OFF_P); float* tmp = (float*)(ws + OFF_TMP); float* logf = (float*)(ws + OFF_LOGF); float* cum = (float*)(ws + OFF_CUM);
    bf16_t* O = (bf16_t*)(ws + OFF_O); bf16_t* H = (bf16_t*)(ws + OFF_H); bf16_t* xs = (bf16_t*)(ws + OFF_XS); float* ys = (float*)(ws + OFF_YS);
    int* tokexp = (int*)(ws + OFF_TOK); int* tokpos = tokexp + 2 * M; int* tokslot = tokpos + 2 * M; float* tokgate = (float*)(tokslot + 2 * M);

    k_wt<0><<<dim3(SWA_NP / 32, D / 32, 2), 256, 0, stream>>>(w_in_swa, wt_swa, D, SWA_IN, SWA_NP, (size_t)D * SWA_IN, SWA_NP * D);
    k_wt<0><<<dim3(FOX_NP / 32, D / 32, 2), 256, 0, stream>>>(w_in_fox, wt_fox, D, FOX_IN, FOX_NP, (size_t)D * FOX_IN, FOX_NP * D);
    k_wt<0><<<dim3(512 / 32, D / 32, 4), 256, 0, stream>>>(w_mem_kv, wt_mkv, D, 512, 512, (size_t)D * 512, (size_t)512 * D);
    k_wt<0><<<dim3(D / 32, D / 32, 4), 256, 0, stream>>>(w_out, wt_out, D, D, D, (size_t)D * D, (size_t)D * D);
    k_wt<1><<<dim3(2 * DFF / 32, D / 32, 2), 256, 0, stream>>>(w_ffn_in, wt_fin, D, 2 * DFF, 2 * DFF, (size_t)D * 2 * DFF, (size_t)2 * DFF * D);
    k_wt<0><<<dim3(D / 32, DFF / 32, 2), 256, 0, stream>>>(w_ffn_out, wt_fout, DFF, D, D, (size_t)DFF * D, (size_t)D * DFF);
    k_wt<1><<<dim3(2 * DFF / 32, D / 32, 16), 256, 0, stream>>>(w_exp_in, wt_ein, D, 2 * DFF, 2 * DFF, (size_t)D * 2 * DFF, (size_t)2 * DFF * D);
    k_wt<0><<<dim3(D / 32, DFF / 32, 16), 256, 0, stream>>>(w_exp_out, wt_eout, DFF, D, D, (size_t)DFF * D, (size_t)D * DFF);
    k_cvt_bf16<<<2048, 256, 0, stream>>>(x_in, xb, (size_t)M * D);
    k_cvt_bf16<<<1024, 256, 0, stream>>>(mem, memb, (size_t)MROWS * D);
    k_rope_table<<<(M * 8 + 255) / 256, 256, 0, stream>>>(pos, cs);
    for (int i = 0; i < DEPTH; ++i) {
        EpiBf16 e{kvm + (size_t)i * MROWS * 512, 512, 512};
        k_gemm<EpiBf16><<<dim3(512 / 128, MROWS / 128), 256, 0, stream>>>(memb, D, wt_mkv + (size_t)i * 512 * D, D, D, e, nullptr, 0);
    }
    const float* xcur = x_in;
    for (int i = 0; i < DEPTH; ++i) {
        const int j = i / 2; const bool swa = (i % 2 == 0);
        float* xmid = x32; float* xend = (i == DEPTH - 1) ? out : x32;
        if (swa) {
            EpiF32 e{tmp, SWA_IN, SWA_IN};
            k_gemm<EpiF32><<<dim3(SWA_NP / 128, M / 128), 256, 0, stream>>>(xb, D, wt_swa + (size_t)j * SWA_NP * D, D, D, e, nullptr, 0);
            k_post_swa<<<(unsigned)(((size_t)M * SWA_IN + 255) / 256), 256, 0, stream>>>(tmp, cs, P);
            k_attn<0><<<dim3(32, 12, 8), 64, 0, stream>>>(P, SWA_IN, nullptr, sinks + j * 12, O);
            k_attn<2><<<dim3(32, 4, 8), 64, 0, stream>>>(P, SWA_IN, kvm + (size_t)i * MROWS * 512, nullptr, O);
        } else {
            EpiF32 e{tmp, FOX_IN, FOX_IN};
            k_gemm<EpiF32><<<dim3(FOX_NP / 128, M / 128), 256, 0, stream>>>(xb, D, wt_fox + (size_t)j * FOX_NP * D, D, D, e, nullptr, 0);
            k_post_fox<<<(unsigned)(((size_t)M * FOX_IN + 255) / 256), 256, 0, stream>>>(tmp, b_forget + j * 12, P, logf);
            k_cumsum<<<96, 64, 0, stream>>>(logf, cum);
            k_attn<1><<<dim3(32, 12, 8), 64, 0, stream>>>(P, FOX_P, nullptr, cum, O);
            k_attn<2><<<dim3(32, 4, 8), 64, 0, stream>>>(P, FOX_P, kvm + (size_t)i * MROWS * 512, nullptr, O);
        }
        { EpiF32 e{tmp, D, D};
          k_gemm<EpiF32><<<dim3(D / 128, M / 128), 256, 0, stream>>>(O, D, wt_out + (size_t)i * D * D, D, D, e, nullptr, 0);
          k_ln<<<M / 4, 256, 0, stream>>>(xcur, tmp, ln_a_g + i * D, ln_a_b + i * D, xmid, xb); }
        if (swa) {
            EpiSwiglu e{H, DFF};
            k_gemm<EpiSwiglu><<<dim3(2 * DFF / 128, M / 128), 256, 0, stream>>>(xb, D, wt_fin + (size_t)j * 2 * DFF * D, D, D, e, nullptr, 0);
            EpiF32 e2{tmp, D, D};
            k_gemm<EpiF32><<<dim3(D / 128, M / 128), 256, 0, stream>>>(H, DFF, wt_fout + (size_t)j * D * DFF, DFF, DFF, e2, nullptr, 0);
            k_ln<<<M / 4, 256, 0, stream>>>(xmid, tmp, ln_f_g + i * D, ln_f_b + i * D, xend, xb);
        } else {
            hipMemsetAsync(meta, 0, 64, stream);
            k_router<<<M / 4, 256, 0, stream>>>(xmid, w_router + (size_t)j * D * 8, b_router + j * 8, meta, tokexp, tokpos, tokgate);
            k_starts<<<1, 64, 0, stream>>>(meta);
            k_scatter<<<M / 4, 256, 0, stream>>>(xb, meta, tokexp, tokpos, tokslot, xs);
            for (int e = 0; e < NEXP; ++e) {
                EpiSwiglu ep{H, DFF};
                k_gemm<EpiSwiglu><<<dim3(2 * DFF / 128, M / 128), 256, 0, stream>>>(xs, D, wt_ein + (size_t)(j * NEXP + e) * 2 * DFF * D, D, D, ep, meta, e);
            }
            for (int e = 0; e < NEXP; ++e) {
                EpiF32 ep{ys, D, D};
                k_gemm<EpiF32><<<dim3(D / 128, M / 128), 256, 0, stream>>>(H, DFF, wt_eout + (size_t)(j * NEXP + e) * D * DFF, DFF, DFF, ep, meta, e);
            }
            k_ln_moe<<<M / 4, 256, 0, stream>>>(xmid, ys, tokslot, tokgate, ln_f_g + i * D, ln_f_b + i * D, xend, xb);
        }
        xcur = xend;
    }
}
```
